# Optimizing an MI355X kernel written in HIP

```python
import math
import jax, jax.numpy as jnp
from jax import lax
import numpy as np

D_MODEL = 1024
BATCH = 8
SEQ = 2048
DEPTH = 2
DEC_BATCH = 16
DEC_SEQ = 64
PAST_LEN = 2048

CHUNK = 64
D_MIX = D_MODEL
D_ATTN = D_MIX // 2
D_CONV = D_MIX - D_ATTN
N_DIFF_HEADS = 4
N_SUB_HEADS = 2 * N_DIFF_HEADS
HEAD_DIM = D_ATTN // N_SUB_HEADS
V_DIM = 2 * HEAD_DIM
CONV_WIDTH = 31
CONV_HIST = CONV_WIDTH - 1
D_FF = 4 * D_MODEL
D_IN_PROJ = 3 * D_ATTN + 2 * D_CONV
ROPE_THETA = 10000.0
Q_BLOCK = 128
LN_EPS = 1e-5
RMS_EPS = 1e-5
DEEPNORM_ALPHA = (2.0 * DEPTH) ** 0.25
DEEPNORM_BETA = (8.0 * DEPTH) ** -0.25

kernel_name = "hymba_diffattn_conformer_stream_step"


def lambda_init(layer):
    return 0.8 - 0.6 * math.exp(-0.3 * layer)


def layer_norm(x, g, b):
    xf = x.astype(jnp.float32)
    mu = jnp.mean(xf, axis=-1, keepdims=True)
    var = jnp.mean(jnp.square(xf - mu), axis=-1, keepdims=True)
    return ((xf - mu) * lax.rsqrt(var + LN_EPS) * g + b).astype(x.dtype)


def rope(x, pos):
    half = HEAD_DIM // 2
    inv = ROPE_THETA ** (-jnp.arange(half, dtype=jnp.float32) / half)
    ang = pos.astype(jnp.float32)[:, None] * inv[None, :]
    cos = jnp.cos(ang)[None, :, None, :]
    sin = jnp.sin(ang)[None, :, None, :]
    xf = x.astype(jnp.float32)
    x1, x2 = xf[..., :half], xf[..., half:]
    return jnp.concatenate([x1 * cos - x2 * sin, x2 * cos + x1 * sin], axis=-1).astype(x.dtype)


def diff_core(q, k, v, mask, lam, sub_g, lam_init):
    B, Tq = q.shape[0], q.shape[1]
    Tk = k.shape[1]
    s = jnp.einsum('bqsd,bksd->bsqk', q, k).astype(jnp.float32) * (HEAD_DIM ** -0.5)
    if mask is not None:
        s = jnp.where(mask[None, None], s, -1e30)
    p = jax.nn.softmax(s, axis=-1).reshape(B, N_DIFF_HEADS, 2, Tq, Tk)
    a = p[:, :, 0] - lam * p[:, :, 1]
    o = jnp.einsum('bhqk,bkhe->bqhe', a, v.astype(jnp.float32))
    o = o * lax.rsqrt(jnp.mean(jnp.square(o), axis=-1, keepdims=True) + RMS_EPS)
    return (o * sub_g * (1.0 - lam_init)).astype(q.dtype)


def prompt_diff_attention(q, k, v, lam, sub_g, lam_init):
    B, T = q.shape[0], q.shape[1]
    nb = T // Q_BLOCK
    qb = q.reshape(B, nb, Q_BLOCK, N_SUB_HEADS, HEAD_DIM).transpose(1, 0, 2, 3, 4)
    key_chunk = jnp.arange(T) // CHUNK

    def one_block(args):
        q_i, i = args
        q_chunk = (i * Q_BLOCK + jnp.arange(Q_BLOCK)) // CHUNK
        mask = key_chunk[None, :] <= q_chunk[:, None]
        return diff_core(q_i, k, v, mask, lam, sub_g, lam_init)

    out = lax.map(one_block, (qb, jnp.arange(nb)))
    return out.transpose(1, 0, 2, 3, 4).reshape(B, T, N_DIFF_HEADS, V_DIM)


def causal_depthwise_conv(u, hist, w, b):
    full = jnp.concatenate([hist, u], axis=1)
    y = lax.conv_general_dilated(full, w[:, None, :], window_strides=(1,), padding='VALID',
                                 dimension_numbers=('NWC', 'WIO', 'NWC'),
                                 feature_group_count=D_CONV)
    return y + b, full[:, -CONV_HIST:]


def trunk_layer(l, x, pos, past_k, past_v, past_conv, p):
    B, T, _ = x.shape
    lam_init = lambda_init(l)
    proj = jnp.einsum('btd,de->bte', x, p['w_in'][l])
    q, k, v, ca, cg = jnp.split(proj, [D_ATTN, 2 * D_ATTN, 3 * D_ATTN, 3 * D_ATTN + D_CONV], axis=-1)
    q = rope(q.reshape(B, T, N_SUB_HEADS, HEAD_DIM), pos)
    k = rope(k.reshape(B, T, N_SUB_HEADS, HEAD_DIM), pos)
    v = v.reshape(B, T, N_DIFF_HEADS, V_DIM)
    lam = (jnp.exp(jnp.sum(p['lambda_q1'][l].astype(jnp.float32) * p['lambda_k1'][l].astype(jnp.float32)))
           - jnp.exp(jnp.sum(p['lambda_q2'][l].astype(jnp.float32) * p['lambda_k2'][l].astype(jnp.float32)))
           + lam_init)
    sub_g = p['subln_g'][l].astype(jnp.float32)
    if past_k is None:
        attn = prompt_diff_attention(q, k, v, lam, sub_g, lam_init)
        hist = jnp.zeros((B, CONV_HIST, D_CONV), x.dtype)
    else:
        k_all = jnp.concatenate([past_k, k], axis=1)
        v_all = jnp.concatenate([past_v, v], axis=1)
        attn = diff_core(q, k_all, v_all, None, lam, sub_g, lam_init)
        hist = past_conv
    u = ca * jax.nn.sigmoid(cg)
    c, conv_state = causal_depthwise_conv(u, hist, p['conv_w'][l], p['conv_b'][l])
    c = jax.nn.silu(layer_norm(c, p['conv_ln_g'][l], p['conv_ln_b'][l]))
    mix = jnp.concatenate([attn.reshape(B, T, D_ATTN), c], axis=-1)
    y = jnp.einsum('bte,ed->btd', mix, p['w_out'][l])
    x = layer_norm(DEEPNORM_ALPHA * x + y, p['ln1_g'][l], p['ln1_b'][l])
    h = jnp.square(jax.nn.relu(jnp.einsum('btd,df->btf', x, p['w_ff1'][l])))
    x = layer_norm(DEEPNORM_ALPHA * x + jnp.einsum('btf,fd->btd', h, p['w_ff2'][l]), p['ln2_g'][l], p['ln2_b'][l])
    return x, k, v, conv_state


def setup_inputs(seed: int = 0) -> dict:
    key = jax.random.key(seed)
    ks = jax.random.split(key, 24)
    f32 = jnp.float32
    nrm = lambda k, shape, s: jax.random.normal(k, shape, f32) * s
    w_in = nrm(ks[0], (DEPTH, D_MODEL, D_IN_PROJ), D_MODEL ** -0.5)
    w_in = w_in.at[..., 2 * D_ATTN:3 * D_ATTN].multiply(DEEPNORM_BETA)
    return {
        'x_prompt': nrm(ks[1], (BATCH, SEQ, D_MODEL), 1.0),
        'x_sample': nrm(ks[2], (DEC_BATCH, DEC_SEQ, D_MODEL), 1.0),
        'cache_k': nrm(ks[3], (DEPTH, DEC_BATCH, PAST_LEN, N_SUB_HEADS, HEAD_DIM), 1.0),
        'cache_v': nrm(ks[4], (DEPTH, DEC_BATCH, PAST_LEN, N_DIFF_HEADS, V_DIM), DEEPNORM_BETA),
        'cache_conv': nrm(ks[5], (DEPTH, DEC_BATCH, CONV_HIST, D_CONV), 0.5),
        'w_in': w_in,
        'lambda_q1': nrm(ks[6], (DEPTH, HEAD_DIM), 0.1),
        'lambda_k1': nrm(ks[7], (DEPTH, HEAD_DIM), 0.1),
        'lambda_q2': nrm(ks[8], (DEPTH, HEAD_DIM), 0.1),
        'lambda_k2': nrm(ks[9], (DEPTH, HEAD_DIM), 0.1),
        'subln_g': 1.0 + nrm(ks[10], (DEPTH, V_DIM), 0.02),
        'conv_w': nrm(ks[11], (DEPTH, CONV_WIDTH, D_CONV), CONV_WIDTH ** -0.5),
        'conv_b': nrm(ks[12], (DEPTH, D_CONV), 0.02),
        'conv_ln_g': 1.0 + nrm(ks[13], (DEPTH, D_CONV), 0.02),
        'conv_ln_b': nrm(ks[14], (DEPTH, D_CONV), 0.02),
        'w_out': nrm(ks[15], (DEPTH, D_MIX, D_MODEL), DEEPNORM_BETA * D_MIX ** -0.5),
        'ln1_g': 1.0 + nrm(ks[16], (DEPTH, D_MODEL), 0.02),
        'ln1_b': nrm(ks[17], (DEPTH, D_MODEL), 0.02),
        'w_ff1': nrm(ks[18], (DEPTH, D_MODEL, D_FF), DEEPNORM_BETA * D_MODEL ** -0.5),
        'w_ff2': nrm(ks[19], (DEPTH, D_FF, D_MODEL), DEEPNORM_BETA * D_FF ** -0.5),
        'ln2_g': 1.0 + nrm(ks[20], (DEPTH, D_MODEL), 0.02),
        'ln2_b': nrm(ks[21], (DEPTH, D_MODEL), 0.02),
    }


def reference(x_prompt, x_sample, cache_k, cache_v, cache_conv, w_in, lambda_q1, lambda_k1,
              lambda_q2, lambda_k2, subln_g, conv_w, conv_b, conv_ln_g, conv_ln_b, w_out,
              ln1_g, ln1_b, w_ff1, w_ff2, ln2_g, ln2_b):
    p = {'w_in': w_in, 'lambda_q1': lambda_q1, 'lambda_k1': lambda_k1, 'lambda_q2': lambda_q2,
         'lambda_k2': lambda_k2, 'subln_g': subln_g, 'conv_w': conv_w, 'conv_b': conv_b,
         'conv_ln_g': conv_ln_g, 'conv_ln_b': conv_ln_b, 'w_out': w_out, 'ln1_g': ln1_g,
         'ln1_b': ln1_b, 'w_ff1': w_ff1, 'w_ff2': w_ff2, 'ln2_g': ln2_g, 'ln2_b': ln2_b}
    T_p = x_prompt.shape[1]
    T_s = x_sample.shape[1]
    P = cache_k.shape[2]
    pos_p = jnp.arange(T_p)
    pos_s = P + jnp.arange(T_s)
    xp, xs = x_prompt, x_sample
    kp, vp, cp, ksl, vsl, csl = [], [], [], [], [], []
    for l in range(DEPTH):
        xp, k_new, v_new, c_new = trunk_layer(l, xp, pos_p, None, None, None, p)
        kp.append(k_new); vp.append(v_new); cp.append(c_new)
        xs, k_new, v_new, c_new = trunk_layer(l, xs, pos_s, cache_k[l], cache_v[l], cache_conv[l], p)
        ksl.append(k_new); vsl.append(v_new); csl.append(c_new)
    new_k_prompt = jnp.stack(kp)
    new_v_prompt = jnp.stack(vp)
    new_conv_prompt = jnp.stack(cp)
    new_k_sample = jnp.stack(ksl)
    new_v_sample = jnp.stack(vsl)
    new_conv_sample = jnp.stack(csl)
    return (xp, xs, new_k_prompt, new_v_prompt, new_conv_prompt, new_k_sample, new_v_sample, new_conv_sample)
```

```cpp
#include <hip/hip_runtime.h>
#include <hip/hip_bf16.h>
#include <cstdio>
#include <cstdint>

#ifndef MK_ONE_LAUNCH
#define MK_ONE_LAUNCH 0
#endif

constexpr int D_MODEL = 1024, NB_P = 8, SEQ_P = 2048, NB_S = 16, SEQ_S = 64, PAST = 2048, DEPTH = 2;
constexpr int M_P = NB_P * SEQ_P, M_S = NB_S * SEQ_S, M_ALL = M_P + M_S;
constexpr int D_ATTN = 512, D_CONV = 512, D_FF = 4096, N_IN = 2560, CONV_W = 31, CONV_H = 30;
constexpr float LN_EPS = 1e-5f, RMS_EPS = 1e-5f, DN_ALPHA = 1.4142135623730951f;
constexpr float QSCALE = 0.125f * 1.4426950408889634f;

namespace pg8 {
#define PG8_LAS __attribute__((address_space(3)))
typedef unsigned short bf16_t;
typedef short bf16x8 __attribute__((ext_vector_type(8)));
typedef float f32x4 __attribute__((ext_vector_type(4)));
typedef unsigned u32x4 __attribute__((ext_vector_type(4)));
constexpr int BM = 256, BK = 64, HALF = 128, HTB = HALF * BK * 2  , STAGE_BYTES = 8 * HTB, NXCD = 8, WGM = 8;

__host__ __device__ __forceinline__ int lds_byte(int r, int c) { const int st = (r >> 4) * 2 + (c >> 5), rr = r & 15, cc = c & 31, ob = rr * 64 + cc * 2; return st * 1024 + (ob ^ (((ob >> 9) & 1) << 5)); }
__host__ __device__ __forceinline__ void stage_rc(int b, int& R, int& C) { const int st = b / 1024, sb = b % 1024, swz = sb ^ (((sb >> 9) & 1) << 5); R = (st >> 1) * 16 + swz / 64; C = (st & 1) * 32 + (swz % 64) / 2; }
__host__ __device__ __forceinline__ int perm32(int rho) { const int n = rho >> 4, i = rho & 15; return 8 * (i >> 2) + 4 * n + (i & 3); }

struct Unit { int pm, pn; };
struct Gemm { const bf16_t* A; const bf16_t* Bt; int M, N, K; };

struct StaticOrder {
    int nM, nN, nwg, G, c;
    __host__ __device__ void init(int M, int N, int G_, int c_) { nM = M / BM; nN = N / BM; nwg = nM * nN; G = G_; c = c_; }
    __host__ __device__ bool next(int i, Unit& u) const {
        const long L = (long)i * G + c; if (L >= nwg) return false;
        int wgid = (int)L; { const int q = nwg / NXCD, r = nwg % NXCD, xcd = wgid % NXCD, off = wgid / NXCD; wgid = (xcd < r ? xcd * (q + 1) : r * (q + 1) + (xcd - r) * q) + off; }
        const int nig = WGM * nN, gid = wgid / nig, fm = gid * WGM, gsz = (nM - fm) < WGM ? (nM - fm) : WGM;
        u.pm = fm + ((wgid % nig) % gsz); u.pn = (wgid % nig) / gsz; return true;
    }
    __device__ __forceinline__ void a_ready(const Unit&) const {}
    __device__ __forceinline__ void done(const Unit&) const {}
};

__device__ __forceinline__ unsigned cvt_pk_bf16(float lo, float hi) { unsigned r; asm volatile("v_cvt_pk_bf16_f32 %0, %1, %2" : "=v"(r) : "v"(lo), "v"(hi)); return r; }
typedef float f32x2 __attribute__((ext_vector_type(2)));

typedef unsigned u32x2 __attribute__((ext_vector_type(2)));

struct EpiRelu2 {
    static constexpr bool PERM = true, AFTER_DRAIN = false;
    bf16_t* O; int ldc;
    __device__ __forceinline__ void operator()(const f32x4 (&acc)[2][2][4][2], const Unit& u, int wr, int wc, int fr, int fq) const {
        const int row0 = u.pm * BM + wr * 64 + fr; const int col0 = u.pn * BM + wc * 32 + 8 * fq;
#pragma unroll
        for (int ai = 0; ai < 2; ++ai)
#pragma unroll
            for (int m = 0; m < 4; ++m) { bf16_t* rowp = O + (size_t)(row0 + ai * HALF + m * 16) * ldc + col0;
#pragma unroll
                for (int bj = 0; bj < 2; ++bj) { f32x4 v0 = acc[ai][bj][m][0], v1 = acc[ai][bj][m][1];
#pragma unroll
                    for (int i = 0; i < 4; ++i) { const float a = fmaxf(v0[i], 0.f), b = fmaxf(v1[i], 0.f); v0[i] = a * a; v1[i] = b * b; }
                    u32x4 w; w.x = cvt_pk_bf16(v0[0], v0[1]); w.y = cvt_pk_bf16(v0[2], v0[3]); w.z = cvt_pk_bf16(v1[0], v1[1]); w.w = cvt_pk_bf16(v1[2], v1[3]);
                    *(u32x4*)(rowp + bj * HALF) = w; } }
    }
};

struct EpiRes {
    static constexpr bool PERM = false, AFTER_DRAIN = false;
    const float* resP; const float* resS; float* Y; float alpha;
    __device__ __forceinline__ void operator()(const f32x4 (&acc)[2][2][4][2], const Unit& u, int wr, int wc, int fr, int fq) const {
        const int col0 = u.pn * BM + wc * 32 + 4 * fq;
#pragma unroll
        for (int ai = 0; ai < 2; ++ai)
#pragma unroll
            for (int m = 0; m < 4; ++m) { const int row = u.pm * BM + ai * HALF + wr * 64 + m * 16 + fr;
                const float* rp = (row < 16384) ? resP + (size_t)row * 1024 : resS + (size_t)(row - 16384) * 1024; float* yp = Y + (size_t)row * 1024;
#pragma unroll
                for (int bj = 0; bj < 2; ++bj)
#pragma unroll
                    for (int n = 0; n < 2; ++n) { const int c = col0 + bj * HALF + n * 16; const f32x4 r = *(const f32x4*)(rp + c); *(f32x4*)(yp + c) = r * alpha + acc[ai][bj][m][n]; } }
    }
};

struct EpiIn {
    static constexpr bool PERM = false, AFTER_DRAIN = false;
    bf16_t *Q, *K, *V, *U;
    float *oKp, *oVp, *oCp, *oKs, *oVs, *oCs;
    const float* rope;
    __device__ __forceinline__ void operator()(const f32x4 (&acc)[2][2][4][2], const Unit& u, int wr, int wc, int fr, int fq) const {
        const int pn = u.pn;
#pragma unroll
        for (int ai = 0; ai < 2; ++ai)
#pragma unroll
            for (int m = 0; m < 4; ++m) {
                const int row = u.pm * BM + ai * HALF + wr * 64 + m * 16 + fr;
                const bool smp = row >= 16384; const int rs = row - 16384;
                if (pn < 4) {
                    const int pos = smp ? (2048 + (rs & 63)) : (row & 2047);
                    const int dd0 = 16 * (wc & 1) + 4 * fq;
                    const f32x4 cs0 = *(const f32x4*)(rope + ((size_t)pos * 32 + dd0) * 2), cs1 = *(const f32x4*)(rope + ((size_t)pos * 32 + dd0) * 2 + 4);
                    const float cc[4] = {cs0[0], cs0[2], cs1[0], cs1[2]}, ss[4] = {cs0[1], cs0[3], cs1[1], cs1[3]};
#pragma unroll
                    for (int bj = 0; bj < 2; ++bj) {
                        const int s = 4 * (pn & 1) + 2 * bj + (wc >> 1);
                        const f32x4 x1 = acc[ai][bj][m][0], x2 = acc[ai][bj][m][1]; f32x4 o1, o2;
#pragma unroll
                        for (int i = 0; i < 4; ++i) { o1[i] = x1[i] * cc[i] - x2[i] * ss[i]; o2[i] = x2[i] * cc[i] + x1[i] * ss[i]; }
                        const size_t off = (size_t)row * 512 + s * 64 + dd0;
                        if (pn < 2) { const f32x4 a = o1 * QSCALE, b = o2 * QSCALE;
                            u32x2 w1; w1.x = cvt_pk_bf16(a[0], a[1]); w1.y = cvt_pk_bf16(a[2], a[3]); u32x2 w2; w2.x = cvt_pk_bf16(b[0], b[1]); w2.y = cvt_pk_bf16(b[2], b[3]);
                            *(u32x2*)(Q + off) = w1; *(u32x2*)(Q + off + 32) = w2;
                        } else {
                            u32x2 w1; w1.x = cvt_pk_bf16(o1[0], o1[1]); w1.y = cvt_pk_bf16(o1[2], o1[3]); u32x2 w2; w2.x = cvt_pk_bf16(o2[0], o2[1]); w2.y = cvt_pk_bf16(o2[2], o2[3]);
                            *(u32x2*)(K + off) = w1; *(u32x2*)(K + off + 32) = w2;
                            float* op = (smp ? oKs + (size_t)rs * 512 : oKp + (size_t)row * 512) + s * 64 + dd0;
                            *(f32x4*)op = o1; *(f32x4*)(op + 32) = o2;
                        }
                    }
                } else if (pn < 6) {
#pragma unroll
                    for (int bj = 0; bj < 2; ++bj)
#pragma unroll
                        for (int n = 0; n < 2; ++n) { const int c = (pn - 4) * 256 + bj * HALF + wc * 32 + n * 16 + 4 * fq; const f32x4 v = acc[ai][bj][m][n];
                            u32x2 w; w.x = cvt_pk_bf16(v[0], v[1]); w.y = cvt_pk_bf16(v[2], v[3]); *(u32x2*)(V + (size_t)row * 512 + c) = w;
                            float* op = (smp ? oVs + (size_t)rs * 512 : oVp + (size_t)row * 512) + c; *(f32x4*)op = v; }
                } else {
                    int hrow = -1; float* hp = nullptr;
                    if (smp) { const int t = rs & 63; if (t >= 34) hp = oCs + ((size_t)(rs >> 6) * 30 + (t - 34)) * 512; }
                    else { const int t = row & 2047; if (t >= 2018) hp = oCp + ((size_t)(row >> 11) * 30 + (t - 2018)) * 512; }
                    (void)hrow;
#pragma unroll
                    for (int bj = 0; bj < 2; ++bj) { const int c = (pn - 6) * 128 + bj * 64 + wc * 16 + 4 * fq; const f32x4 a = acc[ai][bj][m][0], g = acc[ai][bj][m][1]; f32x4 o;
#pragma unroll
                        for (int i = 0; i < 4; ++i) o[i] = a[i] / (1.f + __expf(-g[i]));
                        u32x2 w; w.x = cvt_pk_bf16(o[0], o[1]); w.y = cvt_pk_bf16(o[2], o[3]); *(u32x2*)(U + (size_t)row * 512 + c) = w;
                        if (hp) *(f32x4*)(hp + c) = o; }
                }
            }
    }
};

template <class Epi, class Sched, bool ALIGN_EPI = false, bool SP2 = false>
__device__ __forceinline__ void gemm_phase(PG8_LAS unsigned char* lds, const Gemm g, const Sched& S, const Epi& E) {
    const int tid = threadIdx.x, wid = __builtin_amdgcn_readfirstlane(tid >> 6), lane = tid & 63, wr = wid >> 2, wc = wid & 3, fr = lane & 15, fq = lane >> 4;
    const int K = g.K, nt = K / BK;
    unsigned voffA[2], voffB[2];
#pragma unroll
    for (int i = 0; i < 2; ++i) { int R, C; stage_rc(tid * 16 + i * 8192, R, C); const int Rb = Epi::PERM ? ((R & ~31) + perm32(R & 31)) : R;
        voffA[i] = (unsigned)(R * K + C) * 2u; voffB[i] = (unsigned)(Rb * K + C) * 2u; }
    const size_t kstep = (size_t)(BK * 2);
    const size_t hstep = (size_t)HALF * K * 2;
    const size_t tstep = 2 * hstep;
    const unsigned ldsw = (unsigned)wid * 1024u;
    const int aoff = lds_byte(wr * 64 + fr, fq * 8), boff = lds_byte(wc * 32 + fr, fq * 8);
#define PG8_SA(b, h) (((b) * 2 + (h)) * HTB)
#define PG8_SB(b, h) ((4 + (b) * 2 + (h)) * HTB)
#define PG8_STAGE(bufoff, gbase, voff) do { _Pragma("unroll") for (int _i = 0; _i < 2; ++_i) \
        __builtin_amdgcn_global_load_lds((const unsigned*)((const char*)(gbase) + (voff)[_i]), (PG8_LAS unsigned*)(lds + (bufoff) + ldsw + _i * 8192), 16, 0, 0); } while (0)
#define PG8_LDA(dst, b, h) do { _Pragma("unroll") for (int m = 0; m < 4; ++m) _Pragma("unroll") for (int k = 0; k < 2; ++k) dst[m][k] = *(const PG8_LAS bf16x8*)(lds + PG8_SA(b, h) + aoff + m * 2048 + k * 1024); } while (0)
#define PG8_LDB(dst, b, h) do { _Pragma("unroll") for (int n = 0; n < 2; ++n) _Pragma("unroll") for (int k = 0; k < 2; ++k) dst[n][k] = *(const PG8_LAS bf16x8*)(lds + PG8_SB(b, h) + boff + n * 2048 + k * 1024); } while (0)
#define PG8_MMA(ai, bj, At, Bt) do { __builtin_amdgcn_s_setprio(1); _Pragma("unroll") for (int m = 0; m < 4; ++m) _Pragma("unroll") for (int n = 0; n < 2; ++n) _Pragma("unroll") for (int k = 0; k < 2; ++k) \
        acc[ai][bj][m][n] = __builtin_amdgcn_mfma_f32_16x16x32_bf16(Bt[n][k], At[m][k], acc[ai][bj][m][n], 0, 0, 0); __builtin_amdgcn_s_setprio(0); } while (0)
#define PG8_WAIT_V(n) asm volatile("s_waitcnt vmcnt(" #n ")" ::: "memory")
#define PG8_WAIT_L(n) asm volatile("s_waitcnt lgkmcnt(" #n ")" ::: "memory")
#define PG8_BAR __builtin_amdgcn_s_barrier()
#define PG8_SCHED __builtin_amdgcn_sched_barrier(0)
    Unit cur, nxt; int ui = 0;
    if (!S.next(0, cur)) return;
    f32x4 acc[2][2][4][2];
#pragma unroll
    for (int a = 0; a < 2; ++a)
#pragma unroll
        for (int b = 0; b < 2; ++b)
#pragma unroll
            for (int m = 0; m < 4; ++m)
#pragma unroll
                for (int n = 0; n < 2; ++n) acc[a][b][m][n] = (f32x4){0.f, 0.f, 0.f, 0.f};
    bf16x8 At[4][2], B0[2][2], B1[2][2];
    const char* cA = (const char*)g.A + (size_t)cur.pm * tstep; const char* cB = (const char*)g.Bt + (size_t)cur.pn * tstep;
    S.a_ready(cur);
    if constexpr (SP2) {
        PG8_STAGE(PG8_SB(0, 0), cB, voffB); PG8_STAGE(PG8_SB(0, 1), cB + hstep, voffB); PG8_STAGE(PG8_SA(0, 0), cA, voffA); PG8_STAGE(PG8_SA(0, 1), cA + hstep, voffA);
        if (wr == 1) PG8_BAR;
        PG8_WAIT_V(2); PG8_BAR;
        PG8_STAGE(PG8_SB(1, 0), cB + kstep, voffB); PG8_STAGE(PG8_SA(1, 0), cA + kstep, voffA); PG8_STAGE(PG8_SB(1, 1), cB + hstep + kstep, voffB);
        PG8_WAIT_V(6); PG8_BAR;
    } else {
        PG8_STAGE(PG8_SB(0, 0), cB, voffB); PG8_STAGE(PG8_SA(0, 0), cA, voffA); PG8_STAGE(PG8_SB(0, 1), cB + hstep, voffB); PG8_STAGE(PG8_SA(0, 1), cA + hstep, voffA);
        if (wr == 1) PG8_BAR;
        PG8_WAIT_V(4); PG8_BAR;
        PG8_STAGE(PG8_SB(1, 0), cB + kstep, voffB); PG8_STAGE(PG8_SA(1, 0), cA + kstep, voffA); PG8_STAGE(PG8_SB(1, 1), cB + hstep + kstep, voffB);
        PG8_WAIT_V(6); PG8_BAR;
    }
    for (;;) {
        const bool has_next = S.next(ui + 1, nxt);
        const char* nA = has_next ? (const char*)g.A + (size_t)nxt.pm * tstep : cA; const char* nB = has_next ? (const char*)g.Bt + (size_t)nxt.pn * tstep : cB;
        for (int t = 0; t < nt; t += 2) {
            const bool last = (t == nt - 2);
            const char* a1 = cA + (size_t)(t + 1) * kstep;
            const char* a2 = last ? nA : cA + (size_t)(t + 2) * kstep; const char* b2 = last ? nB : cB + (size_t)(t + 2) * kstep;
            const char* a3 = a2 + kstep; const char* b3 = b2 + kstep;
            if (last && has_next) S.a_ready(nxt);
            if constexpr (SP2) {
            PG8_LDB(B0, 0, 0); PG8_LDB(B1, 0, 1); PG8_SCHED; PG8_LDA(At, 0, 0); PG8_STAGE(PG8_SA(1, 1), a1 + hstep, voffA);
            PG8_WAIT_V(8); PG8_WAIT_L(0); PG8_BAR; PG8_MMA(0, 0, At, B0); PG8_MMA(0, 1, At, B1); PG8_BAR; PG8_SCHED;
            PG8_LDA(At, 0, 1); PG8_STAGE(PG8_SB(0, 0), b2, voffB); PG8_STAGE(PG8_SB(0, 1), b2 + hstep, voffB); PG8_STAGE(PG8_SA(0, 0), a2, voffA);
            PG8_WAIT_V(8); PG8_WAIT_L(0); PG8_BAR; PG8_MMA(1, 0, At, B0); PG8_MMA(1, 1, At, B1); PG8_BAR; PG8_SCHED;
            PG8_LDB(B0, 1, 0); PG8_LDB(B1, 1, 1); PG8_SCHED; PG8_LDA(At, 1, 0); PG8_STAGE(PG8_SA(0, 1), a2 + hstep, voffA);
            PG8_WAIT_V(8); PG8_WAIT_L(0); PG8_BAR; PG8_MMA(0, 0, At, B0); PG8_MMA(0, 1, At, B1); PG8_BAR; PG8_SCHED;
            PG8_LDA(At, 1, 1); PG8_STAGE(PG8_SB(1, 0), b3, voffB); PG8_STAGE(PG8_SB(1, 1), b3 + hstep, voffB); PG8_STAGE(PG8_SA(1, 0), a3, voffA);
            PG8_WAIT_V(8); PG8_WAIT_L(0); PG8_BAR; PG8_MMA(1, 0, At, B0); PG8_MMA(1, 1, At, B1); PG8_BAR; PG8_SCHED;
            } else {
            PG8_LDB(B0, 0, 0); PG8_SCHED; PG8_LDA(At, 0, 0); PG8_STAGE(PG8_SA(1, 1), a1 + hstep, voffA);
            PG8_WAIT_L(8); PG8_BAR; PG8_WAIT_L(0); PG8_MMA(0, 0, At, B0); PG8_BAR; PG8_SCHED;
            PG8_LDB(B1, 0, 1); PG8_STAGE(PG8_SB(0, 0), b2, voffB);
            PG8_BAR; PG8_WAIT_L(0); PG8_MMA(0, 1, At, B1); PG8_BAR;
            PG8_LDA(At, 0, 1); PG8_STAGE(PG8_SA(0, 0), a2, voffA);
            PG8_BAR; PG8_WAIT_L(0); PG8_MMA(1, 0, At, B0); PG8_BAR; PG8_SCHED;
            PG8_STAGE(PG8_SB(0, 1), b2 + hstep, voffB);
            PG8_WAIT_V(6); PG8_BAR; PG8_MMA(1, 1, At, B1); PG8_BAR;
            PG8_LDB(B0, 1, 0); PG8_SCHED; PG8_LDA(At, 1, 0); PG8_STAGE(PG8_SA(0, 1), a2 + hstep, voffA);
            PG8_WAIT_L(8); PG8_BAR; PG8_WAIT_L(0); PG8_MMA(0, 0, At, B0); PG8_BAR; PG8_SCHED;
            PG8_LDB(B1, 1, 1); PG8_STAGE(PG8_SB(1, 0), b3, voffB);
            PG8_BAR; PG8_WAIT_L(0); PG8_MMA(0, 1, At, B1); PG8_BAR;
            PG8_LDA(At, 1, 1); PG8_STAGE(PG8_SA(1, 0), a3, voffA);
            PG8_BAR; PG8_WAIT_L(0); PG8_MMA(1, 0, At, B0); PG8_BAR; PG8_SCHED;
            PG8_STAGE(PG8_SB(1, 1), b3 + hstep, voffB);
            PG8_WAIT_V(6); PG8_BAR; PG8_MMA(1, 1, At, B1); PG8_BAR;
            }
        }
        if constexpr (ALIGN_EPI) { if (wr == 0) PG8_BAR; }
        if constexpr (!Epi::AFTER_DRAIN) { E(acc, cur, wr, wc, fr, fq); S.done(cur); }
        if (!has_next) break;
#pragma unroll
        for (int a = 0; a < 2; ++a)
#pragma unroll
            for (int b = 0; b < 2; ++b)
#pragma unroll
                for (int m = 0; m < 4; ++m)
#pragma unroll
                    for (int n = 0; n < 2; ++n) acc[a][b][m][n] = (f32x4){0.f, 0.f, 0.f, 0.f};
        cur = nxt; cA = nA; cB = nB; ++ui;
        if constexpr (ALIGN_EPI) { if (wr == 1) PG8_BAR; }
    }
    PG8_WAIT_V(0);
    if constexpr (!ALIGN_EPI) { if (wr == 0) PG8_BAR; }
    PG8_BAR;
    if constexpr (Epi::AFTER_DRAIN) { E.fused(acc, cur, wr, wc, fr, fq, lds, wid, lane); S.done(cur); }
#undef PG8_SA
#undef PG8_SB
#undef PG8_STAGE
#undef PG8_LDA
#undef PG8_LDB
#undef PG8_MMA
#undef PG8_WAIT_V
#undef PG8_WAIT_L
#undef PG8_BAR
#undef PG8_SCHED
}
}

constexpr size_t MiB = 1u << 20;
constexpr size_t WS_CTL = 0, CTL_ZERO_BYTES = 1 * MiB;
constexpr size_t WS_ROPE = 1 * MiB;
constexpr size_t WS_WT = 2 * MiB, WT_LAYER = 23 * MiB;
constexpr size_t WT_IN = 0, WT_OUT = 5 * MiB, WT_FF1 = 7 * MiB, WT_FF2 = 15 * MiB;
constexpr size_t WS_XB = 48 * MiB;
constexpr size_t WS_X1F = 82 * MiB;
constexpr size_t WS_QKVU = 150 * MiB, QKVU_STRIDE = 17 * MiB;
constexpr size_t WS_YF = WS_QKVU;
constexpr size_t WS_MIX = 218 * MiB;
constexpr size_t WS_H = 252 * MiB;
constexpr size_t WS_CACHE = 388 * MiB;
constexpr size_t WS_END = 452 * MiB;
static_assert((size_t)M_ALL * 1024 * 2 == 34 * MiB && (size_t)M_ALL * 512 * 2 == 17 * MiB && (size_t)M_ALL * 4096 * 2 == 136 * MiB, "buffer sizes");
constexpr int CW_BAR = 4096;
constexpr int CW_QUEUE = 16384;

constexpr size_t O_YP = 0, O_YS = (size_t)M_P * 1024, O_KP = O_YS + (size_t)M_S * 1024, O_VP = O_KP + (size_t)DEPTH * M_P * 512, O_CP = O_VP + (size_t)DEPTH * M_P * 512,
                 O_KS = O_CP + (size_t)DEPTH * NB_P * CONV_H * 512, O_VS = O_KS + (size_t)DEPTH * M_S * 512, O_CS = O_VS + (size_t)DEPTH * M_S * 512, O_END = O_CS + (size_t)DEPTH * NB_S * CONV_H * 512;
static_assert(O_END == 54214656, "d_out size");

constexpr int RING_OFF = 0, RING_BYTES = 131072;
constexpr int LDSCTL_OFF = RING_BYTES, MISC_OFF = LDSCTL_OFF + 320;
constexpr int ATT_SCR_OFF = RING_BYTES + 1024;
constexpr int LDS_BYTES = 147456;
constexpr int NWAVES = 8;

#define GAS __attribute__((address_space(1)))
#define LAS __attribute__((address_space(3)))
typedef unsigned short bf16;
typedef unsigned v4u __attribute__((ext_vector_type(4)));
typedef unsigned v2u __attribute__((ext_vector_type(2)));
typedef float f32x4 __attribute__((ext_vector_type(4)));
typedef float f32x16 __attribute__((ext_vector_type(16)));
typedef short bf16x8 __attribute__((ext_vector_type(8)));
typedef short s16x4 __attribute__((ext_vector_type(4)));
typedef GAS unsigned gu32;
typedef GAS unsigned long long gu64;
#define RLX_AGENT __ATOMIC_RELAXED, __HIP_MEMORY_SCOPE_AGENT
#define LDS_WAIT() asm volatile("s_waitcnt lgkmcnt(0)" ::: "memory")
#define VM_WAIT() asm volatile("s_waitcnt vmcnt(0)" ::: "memory")
__device__ __forceinline__ unsigned f2bf(float f) { unsigned u = __builtin_bit_cast(unsigned, f); return (u + 0x7fffu + ((u >> 16) & 1u)) >> 16; }
__device__ __forceinline__ unsigned pk2(float lo, float hi) { return f2bf(lo) | (f2bf(hi) << 16); }
__device__ __forceinline__ float bf2f(unsigned short b) { return __builtin_bit_cast(float, (unsigned)b << 16); }

#define XB_TMO      128
#define XB_XCNT(j)  (256  + 64 * (j))
#define XB_XSUB(j)  (1280 + 64 * (j))
#define XB_XGEN(j)  (2304 + 64 * (j))
#define XB_TOP      3328
#define XB_TOPGEN   3392
#define XCD_BAR_WORDS 3456
#define XB_SPIN_CAP (1u << 18)

__device__ __forceinline__ unsigned xb_ld(unsigned* p)              { return __hip_atomic_load(p, __ATOMIC_RELAXED, __HIP_MEMORY_SCOPE_AGENT); }
__device__ __forceinline__ unsigned xb_add(unsigned* p, unsigned v) { return __hip_atomic_fetch_add(p, v, __ATOMIC_RELAXED, __HIP_MEMORY_SCOPE_AGENT); }
__device__ __forceinline__ unsigned xb_xcc_id() { return (unsigned)__builtin_amdgcn_s_getreg((3 << 11) | 20) & 0xFu; }
#define XB_SPIN(cond, bar) do { unsigned _sp = 0; while (cond) { __builtin_amdgcn_s_sleep(1); \
    if ((++_sp & 255u) == 0u) { if (xb_ld(&(bar)[XB_TMO])) break; if (_sp > XB_SPIN_CAP) { atomicAdd(&(bar)[XB_TMO], 1u); break; } } } } while (0)

struct XcdBarrier {
    unsigned* bar; unsigned x;
    volatile LAS unsigned* st;
};

__device__ __forceinline__ XcdBarrier xcd_barrier_post(unsigned* bar, volatile LAS unsigned* st) {
    XcdBarrier b; b.bar = bar; b.x = xb_xcc_id(); b.st = st;
    if (threadIdx.x == 0) (void)xb_add(&bar[XB_XCNT(b.x)], 1u);
    return b;
}
__device__ __forceinline__ void xcd_barrier_complete(unsigned* bar, unsigned x, unsigned& nloc, unsigned& nx) {
    const unsigned G = gridDim.x * gridDim.y * gridDim.z;
    unsigned sum, cnt, mine, sp = 0u;
    for (;;) {
        sum = 0u; cnt = 0u; mine = 0u;
#pragma unroll
        for (unsigned j = 0; j < 16; ++j) { const unsigned c = xb_ld(&bar[XB_XCNT(j)]); sum += c; cnt += (c > 0u) ? 1u : 0u; mine = (j == x) ? c : mine; }
        if (sum == G) break;
        __builtin_amdgcn_s_sleep(1);
        if ((++sp & 255u) == 0u) { if (xb_ld(&bar[XB_TMO])) break; if (sp > XB_SPIN_CAP) { atomicAdd(&bar[XB_TMO], 1u); break; } }
    }
    nloc = mine > 0u ? mine : 1u; nx = cnt > 0u ? cnt : 1u;
}

__device__ __forceinline__ void xcd_barrier(const XcdBarrier& b) {
    asm volatile("s_waitcnt vmcnt(0)" ::: "memory");
    __syncthreads();
    if (threadIdx.x == 0) {
        unsigned* bar = b.bar;
        __builtin_amdgcn_s_waitcnt(0);
        unsigned nloc = b.st[0], nx = b.st[1];
        if (nloc == 0u) { xcd_barrier_complete(bar, b.x, nloc, nx); b.st[0] = nloc; b.st[1] = nx; }
        const unsigned old = xb_add(&bar[XB_XSUB(b.x)], 1u);
        const unsigned gen = old / nloc;
        if (old + 1u == (gen + 1u) * nloc) {
            __builtin_amdgcn_fence(__ATOMIC_RELEASE, "agent");
            asm volatile("s_waitcnt vmcnt(0)" ::: "memory");
            const unsigned og = xb_add(&bar[XB_TOP], 1u);
            const unsigned tg = og / nx;
            if (og + 1u == (tg + 1u) * nx) xb_add(&bar[XB_TOPGEN], 1u);
            else XB_SPIN(xb_ld(&bar[XB_TOPGEN]) == tg, bar);
            __builtin_amdgcn_fence(__ATOMIC_ACQUIRE, "agent");
            xb_add(&bar[XB_XGEN(b.x)], 1u);
            asm volatile("s_waitcnt vmcnt(0)" ::: "memory");
        } else {
            XB_SPIN(xb_ld(&bar[XB_XGEN(b.x)]) == gen, bar);
            __builtin_amdgcn_fence(__ATOMIC_ACQUIRE, "agent");
            asm volatile("s_waitcnt vmcnt(0)" ::: "memory");
        }
    }
    __syncthreads();
}

struct Frame {
    LAS unsigned char* lds;
    volatile LAS unsigned* MISC;
    gu32* ctl;
    int tid, lane, wave;
    int vcu, G;
};

__device__ __forceinline__ float wave_sum(float v) {
#pragma unroll
    for (int o = 1; o < 64; o <<= 1) v += __shfl_xor(v, o);
    return v;
}

__device__ __forceinline__ int in_vrow(int n) {
    if (n < 1024) { const int s = n >> 6, d = n & 63, nsel = d >> 5, dd = d & 31; return (s << 6) + ((dd >> 4) << 5) + (nsel << 4) + (dd & 15); }
    if (n < 1536) return n;
    const int g = (n >= 2048) ? 1 : 0, c = n - (g ? 2048 : 1536), tt = c >> 7, cl = c & 127;
    return 1536 + tt * 256 + (cl >> 6) * 128 + ((cl >> 4) & 3) * 32 + g * 16 + (cl & 15);
}
template <bool MAP_IN>
__device__ __forceinline__ void p0_transpose_item(const float* W, int K, int N, bf16* WT, LAS float* scr, int item, int lane) {
    const int nblk = N / 32, kb = item / nblk, nb = item % nblk, k0 = 64 * kb, n0 = 32 * nb;
#pragma unroll 8
    for (int i = 0; i < 32; ++i) { const int kk = 2 * i + (lane >> 5); scr[kk * 33 + (lane & 31)] = W[(size_t)(k0 + kk) * N + n0 + (lane & 31)]; }
    LDS_WAIT(); asm volatile("" ::: "memory");
    const int c = lane & 7;
#pragma unroll
    for (int j = 0; j < 4; ++j) { const int n = (lane >> 3) + 8 * j; const LAS float* s = scr + (8 * c) * 33 + n;
        v4u o; o.x = pk2(s[0 * 33], s[1 * 33]); o.y = pk2(s[2 * 33], s[3 * 33]); o.z = pk2(s[4 * 33], s[5 * 33]); o.w = pk2(s[6 * 33], s[7 * 33]);
        const int drow = MAP_IN ? in_vrow(n0 + n) : (n0 + n);
        *(GAS v4u*)(WT + (size_t)drow * K + k0 + 8 * c) = o; }
    LDS_WAIT(); asm volatile("" ::: "memory");
}
__constant__ float ROPE_INV[32] = {
    1.000000000e+00f, 7.498942093e-01f, 5.623413252e-01f, 4.216965034e-01f, 3.162277660e-01f, 2.371373706e-01f, 1.778279410e-01f, 1.333521432e-01f,
    1.000000000e-01f, 7.498942093e-02f, 5.623413252e-02f, 4.216965034e-02f, 3.162277660e-02f, 2.371373706e-02f, 1.778279410e-02f, 1.333521432e-02f,
    1.000000000e-02f, 7.498942093e-03f, 5.623413252e-03f, 4.216965034e-03f, 3.162277660e-03f, 2.371373706e-03f, 1.778279410e-03f, 1.333521432e-03f,
    1.000000000e-03f, 7.498942093e-04f, 5.623413252e-04f, 4.216965034e-04f, 3.162277660e-04f, 2.371373706e-04f, 1.778279410e-04f, 1.333521432e-04f };
__device__ __forceinline__ void sincos_d(double x, double& s, double& c) {
    const double k = __builtin_rint(x * 0.63661977236758134308);
    double r = __builtin_fma(-k, 1.57079632679489655800, x); r = __builtin_fma(-k, 6.12323399573676603587e-17, r);
    const double r2 = r * r;
    double sp = -1.0 / 1307674368000.0; sp = sp * r2 + 1.0 / 6227020800.0; sp = sp * r2 - 1.0 / 39916800.0; sp = sp * r2 + 1.0 / 362880.0; sp = sp * r2 - 1.0 / 5040.0; sp = sp * r2 + 1.0 / 120.0; sp = sp * r2 - 1.0 / 6.0; sp = sp * r2 + 1.0; sp *= r;
    double cp = 1.0 / 20922789888000.0; cp = cp * r2 - 1.0 / 87178291200.0; cp = cp * r2 + 1.0 / 479001600.0; cp = cp * r2 - 1.0 / 3628800.0; cp = cp * r2 + 1.0 / 40320.0; cp = cp * r2 - 1.0 / 720.0; cp = cp * r2 + 1.0 / 24.0; cp = cp * r2 - 0.5; cp = cp * r2 + 1.0;
    const int q = (int)((long long)k & 3);
    s = (q == 0) ? sp : (q == 1) ? cp : (q == 2) ? -sp : -cp;
    c = (q == 0) ? cp : (q == 1) ? -sp : (q == 2) ? -cp : sp;
}
__device__ __forceinline__ void convert_cache(const Frame& F, const float* ck, const float* cv, bf16* dst, int l) {
    const size_t n8 = (size_t)NB_S * PAST * 512 / 8;
    const size_t gt = (size_t)F.vcu * 512 + F.tid, NT = (size_t)F.G * 512;
    for (int which = 0; which < 2; ++which) {
        const GAS f32x4* src = (const GAS f32x4*)((which ? cv : ck) + (size_t)l * NB_S * PAST * 512); GAS v4u* d = (GAS v4u*)(dst + (size_t)which * NB_S * PAST * 512);
        for (size_t i = gt; i < n8; i += NT) { const f32x4 a = src[2 * i], b = src[2 * i + 1]; v4u o; o.x = pk2(a[0], a[1]); o.y = pk2(a[2], a[3]); o.z = pk2(b[0], b[1]); o.w = pk2(b[2], b[3]); d[i] = o; }
    }
}

__device__ __forceinline__ void p0_prologue_impl(const Frame& F, const float* const __attribute__((address_space(4)))* in, unsigned char* ws) {
    LAS float* scr = (LAS float*)(F.lds + RING_OFF + F.wave * 16384);
    const int gw = F.vcu * NWAVES + F.wave, NGW = F.G * NWAVES;
    constexpr int I_IN = (1024 / 64) * (N_IN / 32), I_OUT = (1024 / 64) * (1024 / 32), I_F1 = (1024 / 64) * (D_FF / 32), I_F2 = (D_FF / 64) * (1024 / 32);
    constexpr int I_LAYER = I_IN + I_OUT + I_F1 + I_F2, NITEMS = DEPTH * I_LAYER;
    for (int it = gw; it < NITEMS; it += NGW) {
        const int l = it / I_LAYER; int r = it % I_LAYER;
        bf16* wt = (bf16*)(ws + WS_WT + (size_t)l * WT_LAYER);
        if (r < I_IN) { p0_transpose_item<true>(in[5] + (size_t)l * 1024 * N_IN, 1024, N_IN, (bf16*)((unsigned char*)wt + WT_IN), scr, r, F.lane); continue; } r -= I_IN;
        if (r < I_OUT) { p0_transpose_item<false>(in[15] + (size_t)l * 1024 * 1024, 1024, 1024, (bf16*)((unsigned char*)wt + WT_OUT), scr, r, F.lane); continue; } r -= I_OUT;
        if (r < I_F1) { p0_transpose_item<false>(in[18] + (size_t)l * 1024 * D_FF, 1024, D_FF, (bf16*)((unsigned char*)wt + WT_FF1), scr, r, F.lane); continue; } r -= I_F1;
        p0_transpose_item<false>(in[19] + (size_t)l * D_FF * 1024, D_FF, 1024, (bf16*)((unsigned char*)wt + WT_FF2), scr, r, F.lane);
    }
    bf16* XB = (bf16*)(ws + WS_XB);
    for (int m = gw; m < M_ALL; m += NGW) {
        const float* xr = (m < M_P) ? in[0] + (size_t)m * 1024 : in[1] + (size_t)(m - M_P) * 1024;
        const GAS f32x4* x4 = (const GAS f32x4*)xr + F.lane; GAS v2u* o8 = (GAS v2u*)(XB + (size_t)m * 1024) + F.lane;
#pragma unroll
        for (int j = 0; j < 4; ++j) { const f32x4 v = x4[64 * j]; v2u o; o.x = pk2(v[0], v[1]); o.y = pk2(v[2], v[3]); o8[64 * j] = o; }
    }
    { float* rope = (float*)(ws + WS_ROPE); const int gt = F.vcu * 512 + F.tid, NT = F.G * 512;
      for (int e = gt; e < (PAST + SEQ_S) * 32; e += NT) { const int pos = e >> 5, i = e & 31; const float ang = (float)pos * ROPE_INV[i]; double s, c; sincos_d((double)ang, s, c);
          rope[2 * e] = (float)c; rope[2 * e + 1] = (float)s; } }
    convert_cache(F, in[2], in[3], (bf16*)(ws + WS_CACHE), 0);
}

__device__ __forceinline__ void ln_rows(const Frame& F, const float* Y, const float* g, const float* b, float* outF, bf16* outB) {
    const int gw = F.vcu * NWAVES + F.wave, NGW = F.G * NWAVES;
    f32x4 gv[4], bv[4];
#pragma unroll
    for (int j = 0; j < 4; ++j) { gv[j] = ((const GAS f32x4*)g)[F.lane + 64 * j]; bv[j] = ((const GAS f32x4*)b)[F.lane + 64 * j]; }
    for (int m = gw; m < M_ALL; m += NGW) {
        const GAS f32x4* xr = (const GAS f32x4*)(Y + (size_t)m * 1024) + F.lane;
        f32x4 v[4]; float s = 0.f;
#pragma unroll
        for (int j = 0; j < 4; ++j) { v[j] = xr[64 * j]; s += (v[j][0] + v[j][1]) + (v[j][2] + v[j][3]); }
        const float mean = wave_sum(s) * (1.f / 1024.f); float s2 = 0.f;
#pragma unroll
        for (int j = 0; j < 4; ++j) { v[j] = v[j] - mean; s2 += (v[j][0] * v[j][0] + v[j][1] * v[j][1]) + (v[j][2] * v[j][2] + v[j][3] * v[j][3]); }
        const float rstd = 1.f / sqrtf(wave_sum(s2) * (1.f / 1024.f) + LN_EPS);
        GAS f32x4* of = (GAS f32x4*)(outF + (size_t)m * 1024) + F.lane;
#pragma unroll
        for (int j = 0; j < 4; ++j) { v[j] = v[j] * rstd * gv[j] + bv[j]; of[64 * j] = v[j]; }
        if (outB) { GAS v2u* o8 = (GAS v2u*)(outB + (size_t)m * 1024) + F.lane;
#pragma unroll
            for (int j = 0; j < 4; ++j) { v2u o; o.x = pk2(v[j][0], v[j][1]); o.y = pk2(v[j][2], v[j][3]); o8[64 * j] = o; } }
    }
}

typedef short v4i16_t __attribute__((ext_vector_type(4)));
__device__ __forceinline__ int crow(int r, int hi) { return (r & 3) + 8 * (r >> 2) + 4 * hi; }
__device__ __forceinline__ s16x4 vtr(const LAS unsigned char* p) { return __builtin_bit_cast(s16x4, __builtin_amdgcn_ds_read_tr16_b64_v4i16((LAS v4i16_t*)p)); }
__device__ __forceinline__ unsigned cvtpk(float lo, float hi) { unsigned r; asm volatile("v_cvt_pk_bf16_f32 %0, %1, %2" : "=v"(r) : "v"(lo), "v"(hi)); return r; }
struct AttnArgs { const bf16 *Q, *K, *V, *CK, *CV; bf16* MIX; const float* subg; float lam, oscale; };
constexpr int ATT_K = 0, ATT_V = 32768, ATT_X = 65536;

template <bool SMP>
__device__ __forceinline__ void attn_unit(LAS unsigned char* lds, const AttnArgs& A, int b, int h, int qb, int wid, int lane) {
    asm volatile("" : "+v"(lane));
    const int r32 = lane & 31, hi = lane >> 5, sub = wid >> 2, qw = wid & 3;
    const int row0 = SMP ? (M_P + b * 64) : (b * 2048 + qb * 128);
    const int NT = SMP ? 33 : 2 * qb + 2;
    const int my_nt = SMP ? (qw < 2 ? 33 : 0) : (2 * qb + (qw >> 1) + 1);
    const bool active = my_nt > 0;
    bf16x8 qf[4];
    { const bf16* qp = A.Q + (size_t)(row0 + (active ? 32 * qw : 0) + r32) * 512 + (2 * h + sub) * 64 + 8 * hi;
#pragma unroll
      for (int ks = 0; ks < 4; ++ks) qf[ks] = *(const bf16x8*)(qp + 16 * ks); }
    const bf16* Kp = A.K + (size_t)(SMP ? (M_P + b * 64) : b * 2048) * 512;
    const bf16* Vp = A.V + (size_t)(SMP ? (M_P + b * 64) : b * 2048) * 512;
    const bf16* CKp = A.CK + (size_t)b * 2048 * 512; const bf16* CVp = A.CV + (size_t)b * 2048 * 512;
#define ATT_STAGE(t, buf) do { \
        const bf16* kt_ = SMP ? ((t) < 32 ? CKp + (size_t)(t) * 64 * 512 : Kp) : Kp + (size_t)(t) * 64 * 512; \
        const bf16* vt_ = SMP ? ((t) < 32 ? CVp + (size_t)(t) * 64 * 512 : Vp) : Vp + (size_t)(t) * 64 * 512; \
        _Pragma("unroll") for (int i_ = 0; i_ < 2; ++i_) \
            __builtin_amdgcn_global_load_lds((const unsigned*)(kt_ + (size_t)lane * 512 + (2 * h + i_) * 64 + wid * 8), (LAS unsigned*)(lds + ATT_K + (buf) * 16384 + i_ * 8192 + wid * 1024), 16, 0, 0); \
        _Pragma("unroll") for (int i_ = 0; i_ < 2; ++i_) { const int p_ = wid + 8 * i_; \
            __builtin_amdgcn_global_load_lds((const unsigned*)(vt_ + (size_t)(16 * (p_ & 3) + (lane >> 2)) * 512 + h * 128 + (p_ >> 2) * 32 + (lane & 3) * 8), (LAS unsigned*)(lds + ATT_V + (buf) * 16384 + (p_ >> 2) * 4096 + (p_ & 3) * 1024), 16, 0, 0); } \
    } while (0)
    LAS float* scr = (LAS float*)(lds + ATT_SCR_OFF + wid * 256);
    float m_run = -1e30f, l_run = 0.f;
    f32x16 o[4];
#pragma unroll
    for (int d = 0; d < 4; ++d)
#pragma unroll
        for (int r = 0; r < 16; ++r) o[d][r] = 0.f;
    ATT_STAGE(0, 0); VM_WAIT(); __syncthreads();
    for (int t = 0; t < NT; ++t) {
        const int buf = t & 1;
        if (t + 1 < NT) ATT_STAGE(t + 1, buf ^ 1);
        if (t < my_nt) {
            const LAS unsigned char* kb = lds + ATT_K + buf * 16384 + sub * 8192 + hi * 1024 + r32 * 16;
            f32x16 p0, p1;
#pragma unroll
            for (int r = 0; r < 16; ++r) { p0[r] = 0.f; p1[r] = 0.f; }
#pragma unroll
            for (int ks = 0; ks < 4; ++ks) {
                const bf16x8 k0 = *(const LAS bf16x8*)(kb + ks * 2048), k1 = *(const LAS bf16x8*)(kb + ks * 2048 + 512);
                p0 = __builtin_amdgcn_mfma_f32_32x32x16_bf16(k0, qf[ks], p0, 0, 0, 0);
                p1 = __builtin_amdgcn_mfma_f32_32x32x16_bf16(k1, qf[ks], p1, 0, 0, 0);
            }
            float mx = fmaxf(p0[0], p1[0]);
#pragma unroll
            for (int r = 1; r < 16; ++r) mx = fmaxf(mx, fmaxf(p0[r], p1[r]));
            mx = fmaxf(mx, __shfl_xor(mx, 32));
            const float mnew = fmaxf(m_run, mx), alpha = __builtin_amdgcn_exp2f(m_run - mnew);
            m_run = mnew;
            float ls = 0.f;
#pragma unroll
            for (int r = 0; r < 16; ++r) { p0[r] = __builtin_amdgcn_exp2f(p0[r] - mnew); p1[r] = __builtin_amdgcn_exp2f(p1[r] - mnew); ls += p0[r] + p1[r]; }
            l_run = l_run * alpha + ls;
            if (hi == 0) scr[r32] = alpha;
            float av[16];
#pragma unroll
            for (int r = 0; r < 16; ++r) av[r] = scr[crow(r, hi)];
#pragma unroll
            for (int d = 0; d < 4; ++d)
#pragma unroll
                for (int r = 0; r < 16; ++r) o[d][r] *= av[r];
            bf16x8 pa[4];
#pragma unroll
            for (int s = 0; s < 4; ++s) { v4u w;
                if (s < 2) { w.x = cvtpk(p0[8 * s + 0], p0[8 * s + 1]); w.y = cvtpk(p0[8 * s + 2], p0[8 * s + 3]); w.z = cvtpk(p0[8 * s + 4], p0[8 * s + 5]); w.w = cvtpk(p0[8 * s + 6], p0[8 * s + 7]); }
                else { const int s2 = s - 2; w.x = cvtpk(p1[8 * s2 + 0], p1[8 * s2 + 1]); w.y = cvtpk(p1[8 * s2 + 2], p1[8 * s2 + 3]); w.z = cvtpk(p1[8 * s2 + 4], p1[8 * s2 + 5]); w.w = cvtpk(p1[8 * s2 + 6], p1[8 * s2 + 7]); }
                pa[s] = __builtin_bit_cast(bf16x8, w); }
            const LAS unsigned char* vb = lds + ATT_V + buf * 16384 + ((lane >> 4) & 1) * 32 + (lane & 3) * 8 + (4 * hi + ((lane & 15) >> 2)) * 64;
#pragma unroll
            for (int d = 0; d < 4; ++d)
#pragma unroll
                for (int s = 0; s < 4; ++s) {
                    const s16x4 lo = vtr(vb + d * 4096 + s * 1024), hh = vtr(vb + d * 4096 + s * 1024 + 512);
                    const bf16x8 vf = (bf16x8){lo[0], lo[1], lo[2], lo[3], hh[0], hh[1], hh[2], hh[3]};
                    o[d] = __builtin_amdgcn_mfma_f32_32x32x16_bf16(pa[s], vf, o[d], 0, 0, 0);
                }
        }
        VM_WAIT(); __syncthreads();
    }
#undef ATT_STAGE
    { const float lt = l_run + __shfl_xor(l_run, 32); const float inv = active ? 1.f / lt : 0.f;
      if (hi == 0) scr[r32] = inv;
      float av[16];
#pragma unroll
      for (int r = 0; r < 16; ++r) av[r] = scr[crow(r, hi)];
#pragma unroll
      for (int d = 0; d < 4; ++d)
#pragma unroll
          for (int r = 0; r < 16; ++r) o[d][r] *= av[r]; }
    LAS float* xch = (LAS float*)(lds + ATT_X + qw * 16384);
    if (sub == 1 && active) {
#pragma unroll
        for (int d = 0; d < 4; ++d)
#pragma unroll
            for (int r = 0; r < 16; ++r) xch[(d * 16 + r) * 64 + lane] = o[d][r];
    }
    __syncthreads();
    if (sub == 0 && active) {
        float ssq[16];
#pragma unroll
        for (int r = 0; r < 16; ++r) ssq[r] = 0.f;
#pragma unroll
        for (int d = 0; d < 4; ++d)
#pragma unroll
            for (int r = 0; r < 16; ++r) { const float v = o[d][r] - A.lam * xch[(d * 16 + r) * 64 + lane]; o[d][r] = v; ssq[r] += v * v; }
#pragma unroll
        for (int r = 0; r < 16; ++r) { float s = ssq[r]; s += __shfl_xor(s, 1); s += __shfl_xor(s, 2); s += __shfl_xor(s, 4); s += __shfl_xor(s, 8); s += __shfl_xor(s, 16);
            ssq[r] = A.oscale / sqrtf(s * (1.f / 128.f) + RMS_EPS); }
        float gsc[4];
#pragma unroll
        for (int d = 0; d < 4; ++d) gsc[d] = A.subg[32 * d + r32];
        bf16* op = A.MIX + (size_t)(row0 + 32 * qw) * 1024 + h * 128 + r32;
#pragma unroll
        for (int r = 0; r < 16; ++r)
#pragma unroll
            for (int d = 0; d < 4; ++d) op[(size_t)crow(r, hi) * 1024 + 32 * d] = (bf16)f2bf(o[d][r] * ssq[r] * gsc[d]);
    }
}

struct ConvArgs { const bf16* U; const float* hist; const float *w, *bias, *g, *bb; bf16* MIX; };
__device__ __forceinline__ void conv_unit(LAS unsigned char* lds, const ConvArgs& C, int j, int tid, int wid, int lane) {
    asm volatile("" : "+v"(tid), "+v"(lane));
    const int row0 = 32 * j; const bool smp = row0 >= M_P;
    const int b = smp ? ((row0 - M_P) >> 6) : (row0 >> 11), t0 = smp ? ((row0 - M_P) & 63) : (row0 & 2047);
    const int seq0 = row0 - t0;
    LAS unsigned char* ubuf = lds; LAS float* obuf = (LAS float*)(lds + 65536);
    for (int id = tid; id < 62 * 64; id += 512) { const int rr = id >> 6, ch = id & 63, t = t0 - 30 + rr; v4u v;
        if (t >= 0) v = *(const GAS v4u*)(C.U + (size_t)(seq0 + t) * 512 + ch * 8);
        else if (smp) { const GAS f32x4* hp = (const GAS f32x4*)(C.hist + ((size_t)b * 30 + (30 + t)) * 512 + ch * 8); const f32x4 a = hp[0], c2 = hp[1]; v.x = pk2(a[0], a[1]); v.y = pk2(a[2], a[3]); v.z = pk2(c2[0], c2[1]); v.w = pk2(c2[2], c2[3]); }
        else v = (v4u){0u, 0u, 0u, 0u};
        *(LAS v4u*)(ubuf + rr * 1024 + ch * 16) = v; }
    float w[31];
#pragma unroll
    for (int k = 0; k < 31; ++k) w[k] = C.w[k * 512 + tid];
    const float bias = C.bias[tid];
    __syncthreads();
    float acc[32];
#pragma unroll
    for (int i = 0; i < 32; ++i) acc[i] = bias;
#pragma unroll
    for (int k = 0; k < 62; ++k) { const float uk = bf2f(*(const LAS unsigned short*)(ubuf + k * 1024 + tid * 2));
#pragma unroll
        for (int i = 0; i < 32; ++i) if (k - i >= 0 && k - i <= 30) acc[i] += w[k - i] * uk; }
#pragma unroll
    for (int i = 0; i < 32; ++i) obuf[i * 512 + tid] = acc[i];
    __syncthreads();
    f32x4 gv[2], bv[2];
#pragma unroll
    for (int hlf = 0; hlf < 2; ++hlf) { gv[hlf] = ((const GAS f32x4*)C.g)[lane + 64 * hlf]; bv[hlf] = ((const GAS f32x4*)C.bb)[lane + 64 * hlf]; }
#pragma unroll
    for (int q = 0; q < 4; ++q) { const int i = 4 * wid + q;
        f32x4 v[2]; float s = 0.f;
#pragma unroll
        for (int hlf = 0; hlf < 2; ++hlf) { v[hlf] = *(const LAS f32x4*)(obuf + i * 512 + hlf * 256 + lane * 4); s += (v[hlf][0] + v[hlf][1]) + (v[hlf][2] + v[hlf][3]); }
        const float mean = wave_sum(s) * (1.f / 512.f); float s2 = 0.f;
#pragma unroll
        for (int hlf = 0; hlf < 2; ++hlf) { v[hlf] = v[hlf] - mean; s2 += (v[hlf][0] * v[hlf][0] + v[hlf][1] * v[hlf][1]) + (v[hlf][2] * v[hlf][2] + v[hlf][3] * v[hlf][3]); }
        const float rstd = 1.f / sqrtf(wave_sum(s2) * (1.f / 512.f) + LN_EPS);
#pragma unroll
        for (int hlf = 0; hlf < 2; ++hlf) { f32x4 y = v[hlf] * rstd * gv[hlf] + bv[hlf];
#pragma unroll
            for (int e = 0; e < 4; ++e) y[e] = y[e] / (1.f + __expf(-y[e]));
            v2u o; o.x = pk2(y[0], y[1]); o.y = pk2(y[2], y[3]);
            *(GAS v2u*)(C.MIX + (size_t)(row0 + i) * 1024 + 512 + hlf * 256 + lane * 4) = o; }
    }
    __syncthreads();
}

struct Args { const float* in[22]; float* out; unsigned char* ws; int ph_lo, ph_hi; };
constexpr int N_PHASES = 1 + 7 * DEPTH;
constexpr int N_ATT_S = NB_S * 4, N_ATT_P = NB_P * 4 * 16, N_CONV = M_ALL / 32, N_MIX_UNITS = N_ATT_S + N_ATT_P + N_CONV;

typedef const __attribute__((address_space(4))) Args* CArgsP;
__device__ __forceinline__ CArgsP fresh_args() { auto p = __builtin_amdgcn_kernarg_segment_ptr(); asm volatile("" : "+s"(p)); return (CArgsP)p; }
#define PH_IN(k) (lo <= (k) && (k) < hi)
#define PH_BAR(k) do { if (PH_IN(k) && PH_IN((k) + 1)) xcd_barrier(bar); } while (0)

template <int L>
__device__ __forceinline__ void layer_phases(const Frame& F, const XcdBarrier& bar, int lo, int hi) {
    constexpr int P0 = 1 + 7 * L;
    if (PH_IN(P0 + 0)) {
#ifndef SKIP_K0
        CArgsP ap = fresh_args(); unsigned char* const ws = ap->ws; float* const out = ap->out;
        unsigned char* wt = ws + WS_WT + (size_t)L * WT_LAYER;
        pg8::Gemm g{(const bf16*)(ws + WS_XB), (const bf16*)(wt + WT_IN), M_ALL, N_IN, 1024}; pg8::StaticOrder S; S.init(M_ALL, N_IN, F.G, (int)blockIdx.x);
        pg8::EpiIn E{(bf16*)(ws + WS_QKVU), (bf16*)(ws + WS_QKVU + QKVU_STRIDE), (bf16*)(ws + WS_QKVU + 2 * QKVU_STRIDE), (bf16*)(ws + WS_QKVU + 3 * QKVU_STRIDE),
                     out + O_KP + (size_t)L * M_P * 512, out + O_VP + (size_t)L * M_P * 512, out + O_CP + (size_t)L * NB_P * CONV_H * 512,
                     out + O_KS + (size_t)L * M_S * 512, out + O_VS + (size_t)L * M_S * 512, out + O_CS + (size_t)L * NB_S * CONV_H * 512,
                     (const float*)(ws + WS_ROPE)};
        pg8::gemm_phase<pg8::EpiIn, pg8::StaticOrder, true, true>(F.lds + RING_OFF, g, S, E);
#endif
    }
    PH_BAR(P0 + 0);
    if (PH_IN(P0 + 1)) {
        CArgsP ap = fresh_args(); unsigned char* const ws = ap->ws; const float* const __attribute__((address_space(4)))* in = ap->in;
        float lam;
        { const float a1 = in[6][L * 64 + F.lane] * in[7][L * 64 + F.lane], a2 = in[8][L * 64 + F.lane] * in[9][L * 64 + F.lane];
          constexpr float lam_init = (L == 0) ? 0.2f : 0.35550906759f;
          lam = __expf(wave_sum(a1)) - __expf(wave_sum(a2)) + lam_init; }
        constexpr float oscale = (L == 0) ? 0.8f : (1.f - 0.35550906759f);
        bf16* MIX = (bf16*)(ws + WS_MIX); const bf16* CK = (const bf16*)(ws + WS_CACHE);
        const AttnArgs A{(const bf16*)(ws + WS_QKVU), (const bf16*)(ws + WS_QKVU + QKVU_STRIDE), (const bf16*)(ws + WS_QKVU + 2 * QKVU_STRIDE), CK, CK + (size_t)NB_S * PAST * 512, MIX, in[10] + L * 128, lam, oscale};
        const ConvArgs C{(const bf16*)(ws + WS_QKVU + 3 * QKVU_STRIDE), in[4] + (size_t)L * NB_S * CONV_H * 512, in[11] + (size_t)L * CONV_W * 512, in[12] + L * 512, in[13] + L * 512, in[14] + L * 512, MIX};
        gu32* qhead = F.ctl + CW_QUEUE + 64 * L;
        for (;;) {
            if (F.tid == 0) F.MISC[16] = __hip_atomic_fetch_add(qhead, 1u, RLX_AGENT);
            __syncthreads();
            const int idx = __builtin_amdgcn_readfirstlane((int)F.MISC[16]);
            __syncthreads();
            if (idx >= N_MIX_UNITS) break;
#ifndef SKIP_ATT
            if (idx < N_ATT_S) attn_unit<true>(F.lds, A, idx >> 2, idx & 3, 0, F.wave, F.lane);
            else if (idx < N_ATT_S + N_ATT_P) { const int jj = idx - N_ATT_S, qb = 15 - (jj >> 5), bh = jj & 31; attn_unit<false>(F.lds, A, bh >> 2, bh & 3, qb, F.wave, F.lane); }
            else
#endif
#ifndef SKIP_CONV
            conv_unit(F.lds, C, idx - N_ATT_S - N_ATT_P, F.tid, F.wave, F.lane);
#endif
            ;
        }
    }
    PH_BAR(P0 + 1);
    if (PH_IN(P0 + 2)) {
#ifndef SKIP_K2
        CArgsP ap = fresh_args(); unsigned char* const ws = ap->ws;
        unsigned char* wt = ws + WS_WT + (size_t)L * WT_LAYER;
        pg8::Gemm g{(const bf16*)(ws + WS_MIX), (const bf16*)(wt + WT_OUT), M_ALL, 1024, 1024}; pg8::StaticOrder S; S.init(M_ALL, 1024, F.G, (int)blockIdx.x);
        pg8::EpiRes E{(L == 0) ? ap->in[0] : ap->out, (L == 0) ? ap->in[1] : ap->out + (size_t)M_P * 1024, (float*)(ws + WS_YF), DN_ALPHA};
        pg8::gemm_phase<pg8::EpiRes, pg8::StaticOrder, true, true>(F.lds + RING_OFF, g, S, E);
#endif
    }
    PH_BAR(P0 + 2);
    if (PH_IN(P0 + 3)) { CArgsP ap = fresh_args(); unsigned char* const ws = ap->ws; ln_rows(F, (const float*)(ws + WS_YF), ap->in[16] + L * 1024, ap->in[17] + L * 1024, (float*)(ws + WS_X1F), (bf16*)(ws + WS_XB)); }
    PH_BAR(P0 + 3);
    if (PH_IN(P0 + 4)) {
#ifndef SKIP_K4
        CArgsP ap = fresh_args(); unsigned char* const ws = ap->ws;
        unsigned char* wt = ws + WS_WT + (size_t)L * WT_LAYER;
        pg8::Gemm g{(const bf16*)(ws + WS_XB), (const bf16*)(wt + WT_FF1), M_ALL, D_FF, 1024}; pg8::StaticOrder S; S.init(M_ALL, D_FF, F.G, (int)blockIdx.x);
        pg8::EpiRelu2 E{(bf16*)(ws + WS_H), D_FF};
        pg8::gemm_phase<pg8::EpiRelu2, pg8::StaticOrder, true, true>(F.lds + RING_OFF, g, S, E);
#endif
    }
    PH_BAR(P0 + 4);
    if (PH_IN(P0 + 5)) {
#ifndef SKIP_K5
        CArgsP ap = fresh_args(); unsigned char* const ws = ap->ws;
        unsigned char* wt = ws + WS_WT + (size_t)L * WT_LAYER;
        pg8::Gemm g{(const bf16*)(ws + WS_H), (const bf16*)(wt + WT_FF2), M_ALL, 1024, D_FF}; pg8::StaticOrder S; S.init(M_ALL, 1024, F.G, (int)blockIdx.x);
        pg8::EpiRes E{(const float*)(ws + WS_X1F), (const float*)(ws + WS_X1F) + (size_t)M_P * 1024, (float*)(ws + WS_YF), DN_ALPHA};
        pg8::gemm_phase<pg8::EpiRes, pg8::StaticOrder, true, true>(F.lds + RING_OFF, g, S, E);
#endif
    }
    PH_BAR(P0 + 5);
    if (PH_IN(P0 + 6)) {
        CArgsP ap = fresh_args(); unsigned char* const ws = ap->ws;
        ln_rows(F, (const float*)(ws + WS_YF), ap->in[20] + L * 1024, ap->in[21] + L * 1024, ap->out, (L + 1 < DEPTH) ? (bf16*)(ws + WS_XB) : nullptr);
        if (L + 1 < DEPTH) convert_cache(F, ap->in[2], ap->in[3], (bf16*)(ws + WS_CACHE), L + 1);
    }
    PH_BAR(P0 + 6);
}

__global__ void __launch_bounds__(NWAVES * 64, 2) hymba_fwd(Args args) {
    extern __shared__ __attribute__((aligned(16))) unsigned char lds_raw[];
    Frame F;
    F.lds = (LAS unsigned char*)lds_raw;
    F.MISC = (volatile LAS unsigned*)(F.lds + MISC_OFF);
    F.tid = threadIdx.x; F.lane = F.tid & 63; F.wave = __builtin_amdgcn_readfirstlane(F.tid >> 6);
    F.G = gridDim.x; { const int bx = blockIdx.x; F.vcu = (F.G % 8 == 0) ? (bx % 8) * (F.G / 8) + bx / 8 : bx; }
    F.ctl = (gu32*)(args.ws + WS_CTL);
    for (int u = F.tid; u < (LDS_BYTES - LDSCTL_OFF) / 4; u += NWAVES * 64) ((LAS unsigned*)(F.lds + LDSCTL_OFF))[u] = 0u;
    __syncthreads();
    const int lo = args.ph_lo, hi = args.ph_hi;
    XcdBarrier bar; bar.bar = (unsigned*)(F.ctl + CW_BAR); bar.x = 0; bar.st = nullptr;
    if (hi - lo > 1) bar = xcd_barrier_post((unsigned*)(F.ctl + CW_BAR), F.MISC + 8);
    if (PH_IN(0)) {
#ifndef SKIP_P0
        { CArgsP ap = fresh_args(); p0_prologue_impl(F, ap->in, ap->ws); }
#endif
    }
    PH_BAR(0);
    layer_phases<0>(F, bar, lo, hi);
    layer_phases<1>(F, bar, lo, hi);
}

extern "C" void kernel_launch(void* const* d_in, const int* in_sizes, int n_in, void* d_out, int out_size, void* d_ws, size_t ws_size, hipStream_t stream) {
    static int grid = 0;
    if (grid == 0) {
        if (n_in != 22 || out_size != (int)O_END || ws_size < WS_END) { fprintf(stderr, "kernel_launch: unexpected shapes: n_in %d out %d ws %zu\n", n_in, out_size, ws_size); grid = -1; return; }
        int dev = 0, cus = 0, per_cu = 0;
        if (hipGetDevice(&dev) != hipSuccess || hipDeviceGetAttribute(&cus, hipDeviceAttributeMultiprocessorCount, dev) != hipSuccess) { grid = -1; return; }
        if (hipFuncSetAttribute((const void*)hymba_fwd, hipFuncAttributeMaxDynamicSharedMemorySize, LDS_BYTES) != hipSuccess) { fprintf(stderr, "kernel_launch: hipFuncSetAttribute failed\n"); grid = -1; return; }
        if (hipOccupancyMaxActiveBlocksPerMultiprocessor(&per_cu, (const void*)hymba_fwd, NWAVES * 64, LDS_BYTES) != hipSuccess || per_cu < 1) { fprintf(stderr, "kernel_launch: occupancy query says %d blocks per CU\n", per_cu); grid = -1; (void)hipGetLastError(); return; }
        (void)hipGetLastError();
        grid = cus;
    }
    if (grid < 0) return;
    if (hipMemsetAsync((char*)d_ws + WS_CTL, 0, CTL_ZERO_BYTES, stream) != hipSuccess) { fprintf(stderr, "kernel_launch: memset failed\n"); return; }
    Args a{};
    for (int i = 0; i < 22; ++i) a.in[i] = (const float*)d_in[i];
    a.out = (float*)d_out; a.ws = (unsigned char*)d_ws;
#if MK_ONE_LAUNCH
    a.ph_lo = 0; a.ph_hi = N_PHASES;
    hipLaunchKernelGGL(hymba_fwd, dim3(grid), dim3(NWAVES * 64), LDS_BYTES, stream, a);
#else
    for (int p = 0; p < N_PHASES; ++p) { a.ph_lo = p; a.ph_hi = p + 1; hipLaunchKernelGGL(hymba_fwd, dim3(grid), dim3(NWAVES * 64), LDS_BYTES, stream, a); }
#endif
}
```
